# Optimizing an MI355X kernel written in HIP

```python
import jax, jax.numpy as jnp
from jax import lax
import numpy as np

D_MODEL = 1024
BATCH = 4
SEQ = 4096
DEPTH = 2
DEC_BATCH = 2
DEC_SEQ = 8192
PAST_LEN = 128

N_MIXERS = 2
D_FF = 4096
CONV_KERNEL = 31
HEAD_DIM = 64
N_HEADS = D_MODEL // HEAD_DIM
N_KV_HEADS = 4
GROUP = N_HEADS // N_KV_HEADS
WINDOW = 128
BLOCK = 128
ROPE_THETA = 10000.0
EPS = 1e-6
N_SUBLAYER_NORMS = 6
N_CONV_LAYERS = (DEPTH + 1) // 2
N_ATTN_LAYERS = DEPTH // 2
QKV_DIM = (N_HEADS + 2 * N_KV_HEADS) * HEAD_DIM
NEG_INF = -1e30

kernel_name = "hybrid_conformer_swa_encoder"


def rms_norm(x, g):
    xf = x.astype(jnp.float32)
    y = xf * lax.rsqrt(jnp.mean(xf * xf, axis=-1, keepdims=True) + EPS)
    return (y * g.astype(jnp.float32)).astype(x.dtype)


def layer_norm(x, g, b):
    xf = x.astype(jnp.float32)
    mu = jnp.mean(xf, axis=-1, keepdims=True)
    var = jnp.mean(jnp.square(xf - mu), axis=-1, keepdims=True)
    y = (xf - mu) * lax.rsqrt(var + EPS)
    return (y * g.astype(jnp.float32) + b.astype(jnp.float32)).astype(x.dtype)


def swiglu(x, w_gate, w_up, w_down):
    return (jax.nn.silu(x @ w_gate) * (x @ w_up)) @ w_down


def conformer_conv(x, w_pw1, b_pw1, w_dw, b_dw, ln_g, ln_b, w_pw2, b_pw2):
    h = x @ w_pw1 + b_pw1
    a, gate = jnp.split(h, 2, axis=-1)
    h = a * jax.nn.sigmoid(gate)
    h = lax.conv_general_dilated(
        h, w_dw[:, None, :], window_strides=(1,),
        padding=[(CONV_KERNEL // 2, CONV_KERNEL // 2)],
        dimension_numbers=('NWC', 'WIO', 'NWC'),
        feature_group_count=D_MODEL) + b_dw
    h = jax.nn.silu(layer_norm(h, ln_g, ln_b))
    return h @ w_pw2 + b_pw2


def rope(x, pos):
    half = HEAD_DIM // 2
    inv = ROPE_THETA ** (-jnp.arange(half, dtype=jnp.float32) / half)
    ang = pos.astype(jnp.float32)[:, None] * inv[None, :]
    cos = jnp.cos(ang)[None, :, None, :]
    sin = jnp.sin(ang)[None, :, None, :]
    xf = x.astype(jnp.float32)
    x1, x2 = xf[..., :half], xf[..., half:]
    out = jnp.concatenate([x1 * cos - x2 * sin, x2 * cos + x1 * sin], axis=-1)
    return out.astype(x.dtype)


def windowed_gqa(x, w_qkv, w_o, sink):
    B, S, _ = x.shape
    nb = S // BLOCK
    qkv = x @ w_qkv
    q = qkv[..., :N_HEADS * HEAD_DIM].reshape(B, S, N_HEADS, HEAD_DIM)
    k = qkv[..., N_HEADS * HEAD_DIM:(N_HEADS + N_KV_HEADS) * HEAD_DIM].reshape(B, S, N_KV_HEADS, HEAD_DIM)
    v = qkv[..., (N_HEADS + N_KV_HEADS) * HEAD_DIM:].reshape(B, S, N_KV_HEADS, HEAD_DIM)
    pos = jnp.arange(S)
    q = rope(q, pos)
    k = rope(k, pos)

    def band(t):
        tp = jnp.pad(t, ((0, 0), (BLOCK, BLOCK), (0, 0), (0, 0)))
        tp = tp.reshape(B, nb + 2, BLOCK, N_KV_HEADS, HEAD_DIM)
        return jnp.concatenate([tp[:, :-2], tp[:, 1:-1], tp[:, 2:]], axis=2)

    kb, vb = band(k), band(v)
    qb = q.reshape(B, nb, BLOCK, N_KV_HEADS, GROUP, HEAD_DIM)
    s = jnp.einsum('bnqkgd,bnjkd->bnkgqj', qb, kb,
                   preferred_element_type=jnp.float32) * (HEAD_DIM ** -0.5)
    qi = jnp.arange(nb)[:, None, None] * BLOCK + jnp.arange(BLOCK)[None, :, None]
    kj = (jnp.arange(nb)[:, None, None] - 1) * BLOCK + jnp.arange(3 * BLOCK)[None, None, :]
    mask = (jnp.abs(kj - qi) <= WINDOW) & (kj >= 0) & (kj < S)
    s = jnp.where(mask[None, :, None, None], s, NEG_INF)
    sk = sink.astype(jnp.float32).reshape(N_KV_HEADS, GROUP)[None, None, :, :, None, None]
    m = jnp.maximum(jnp.max(s, axis=-1, keepdims=True), sk)
    e = jnp.exp(s - m)
    p = e / (jnp.sum(e, axis=-1, keepdims=True) + jnp.exp(sk - m))
    o = jnp.einsum('bnkgqj,bnjkd->bnqkgd', p.astype(vb.dtype), vb)
    return o.reshape(B, S, N_HEADS * HEAD_DIM) @ w_o


def trunk(x, norm_g, ffn_w_gate, ffn_w_up, ffn_w_down,
          conv_w_pw1, conv_b_pw1, conv_w_dw, conv_b_dw, conv_ln_g, conv_ln_b,
          conv_w_pw2, conv_b_pw2, attn_w_qkv, attn_w_o, attn_sink):
    for i in range(DEPTH):
        g = norm_g[i]
        h = swiglu(rms_norm(x, g[0]), ffn_w_gate[i, 0], ffn_w_up[i, 0], ffn_w_down[i, 0])
        x = x + 0.5 * rms_norm(h, g[1])
        hn = rms_norm(x, g[2])
        j = i // N_MIXERS
        if i % N_MIXERS == 0:
            h = conformer_conv(hn, conv_w_pw1[j], conv_b_pw1[j], conv_w_dw[j], conv_b_dw[j],
                               conv_ln_g[j], conv_ln_b[j], conv_w_pw2[j], conv_b_pw2[j])
        else:
            h = windowed_gqa(hn, attn_w_qkv[j], attn_w_o[j], attn_sink[j])
        x = x + rms_norm(h, g[3])
        h = swiglu(rms_norm(x, g[4]), ffn_w_gate[i, 1], ffn_w_up[i, 1], ffn_w_down[i, 1])
        x = x + 0.5 * rms_norm(h, g[5])
    return x


def setup_inputs(seed: int = 0) -> dict:
    key = jax.random.key(seed)
    ks = jax.random.split(key, 20)
    f32 = jnp.float32
    nrm = lambda k, shape, scale: jax.random.normal(k, shape, f32) * scale
    return {
        "x_prompt": nrm(ks[0], (BATCH, SEQ, D_MODEL), 1.0),
        "x_sample": nrm(ks[1], (DEC_BATCH, DEC_SEQ, D_MODEL), 1.0),
        "norm_g": 1.0 + nrm(ks[2], (DEPTH, N_SUBLAYER_NORMS, D_MODEL), 0.02),
        "ffn_w_gate": nrm(ks[3], (DEPTH, 2, D_MODEL, D_FF), D_MODEL ** -0.5),
        "ffn_w_up": nrm(ks[4], (DEPTH, 2, D_MODEL, D_FF), D_MODEL ** -0.5),
        "ffn_w_down": nrm(ks[5], (DEPTH, 2, D_FF, D_MODEL), D_FF ** -0.5),
        "conv_w_pw1": nrm(ks[6], (N_CONV_LAYERS, D_MODEL, 2 * D_MODEL), D_MODEL ** -0.5),
        "conv_b_pw1": nrm(ks[7], (N_CONV_LAYERS, 2 * D_MODEL), 0.01),
        "conv_w_dw": nrm(ks[8], (N_CONV_LAYERS, CONV_KERNEL, D_MODEL), CONV_KERNEL ** -0.5),
        "conv_b_dw": nrm(ks[9], (N_CONV_LAYERS, D_MODEL), 0.01),
        "conv_ln_g": 1.0 + nrm(ks[10], (N_CONV_LAYERS, D_MODEL), 0.02),
        "conv_ln_b": nrm(ks[11], (N_CONV_LAYERS, D_MODEL), 0.01),
        "conv_w_pw2": nrm(ks[12], (N_CONV_LAYERS, D_MODEL, D_MODEL), D_MODEL ** -0.5),
        "conv_b_pw2": nrm(ks[13], (N_CONV_LAYERS, D_MODEL), 0.01),
        "attn_w_qkv": nrm(ks[14], (N_ATTN_LAYERS, D_MODEL, QKV_DIM), D_MODEL ** -0.5),
        "attn_w_o": nrm(ks[15], (N_ATTN_LAYERS, N_HEADS * HEAD_DIM, D_MODEL), (N_HEADS * HEAD_DIM) ** -0.5),
        "attn_sink": nrm(ks[16], (N_ATTN_LAYERS, N_HEADS), 0.5),
    }


def reference(x_prompt, x_sample, norm_g, ffn_w_gate, ffn_w_up, ffn_w_down,
              conv_w_pw1, conv_b_pw1, conv_w_dw, conv_b_dw, conv_ln_g, conv_ln_b,
              conv_w_pw2, conv_b_pw2, attn_w_qkv, attn_w_o, attn_sink):
    y_prompt = trunk(x_prompt, norm_g, ffn_w_gate, ffn_w_up, ffn_w_down,
                     conv_w_pw1, conv_b_pw1, conv_w_dw, conv_b_dw, conv_ln_g, conv_ln_b,
                     conv_w_pw2, conv_b_pw2, attn_w_qkv, attn_w_o, attn_sink)
    y_sample = trunk(x_sample, norm_g, ffn_w_gate, ffn_w_up, ffn_w_down,
                     conv_w_pw1, conv_b_pw1, conv_w_dw, conv_b_dw, conv_ln_g, conv_ln_b,
                     conv_w_pw2, conv_b_pw2, attn_w_qkv, attn_w_o, attn_sink)
    return (y_prompt, y_sample)
```

```cpp
#include <hip/hip_runtime.h>
#include <hip/hip_cooperative_groups.h>
#include <cstdio>
#include <cstdint>
namespace cg = cooperative_groups;
namespace pg8 {
#define PG8_LAS __attribute__((address_space(3)))
typedef unsigned short bf16_t;
typedef short bf16x8 __attribute__((ext_vector_type(8)));
typedef float f32x4 __attribute__((ext_vector_type(4)));
typedef unsigned u32x4 __attribute__((ext_vector_type(4)));
constexpr int BM = 256, BK = 64, HALF = 128, HTB = HALF * BK * 2  , STAGE_BYTES = 8 * HTB, NXCD = 8, WGM = 8;

__host__ __device__ __forceinline__ int lds_byte(int r, int c) { const int st = (r >> 4) * 2 + (c >> 5), rr = r & 15, cc = c & 31, ob = rr * 64 + cc * 2; return st * 1024 + (ob ^ (((ob >> 9) & 1) << 5)); }
__host__ __device__ __forceinline__ void stage_rc(int b, int& R, int& C) { const int st = b / 1024, sb = b % 1024, swz = sb ^ (((sb >> 9) & 1) << 5); R = (st >> 1) * 16 + swz / 64; C = (st & 1) * 32 + (swz % 64) / 2; }
__host__ __device__ __forceinline__ int perm32(int rho) { const int n = rho >> 4, i = rho & 15; return 8 * (i >> 2) + 4 * n + (i & 3); }

struct Unit { int pm, pn; };
struct Gemm { const bf16_t* A; const bf16_t* Bt; int M, N, K; };

struct StaticOrder {
    int nM, nN, nwg, G, c;
    __host__ __device__ void init(int M, int N, int G_, int c_) { nM = M / BM; nN = N / BM; nwg = nM * nN; G = G_; c = c_; }
    __host__ __device__ bool next(int i, Unit& u) const {
        const long L = (long)i * G + c; if (L >= nwg) return false;
        int wgid = (int)L; { const int q = nwg / NXCD, r = nwg % NXCD, xcd = wgid % NXCD, off = wgid / NXCD; wgid = (xcd < r ? xcd * (q + 1) : r * (q + 1) + (xcd - r) * q) + off; }
        const int nig = WGM * nN, gid = wgid / nig, fm = gid * WGM, gsz = (nM - fm) < WGM ? (nM - fm) : WGM;
        u.pm = fm + ((wgid % nig) % gsz); u.pn = (wgid % nig) / gsz; return true;
    }
    __device__ __forceinline__ void a_ready(const Unit&) const {}
    __device__ __forceinline__ void done(const Unit&) const {}
};

__device__ __forceinline__ unsigned cvt_pk_bf16(float lo, float hi) { unsigned r; asm volatile("v_cvt_pk_bf16_f32 %0, %1, %2" : "=v"(r) : "v"(lo), "v"(hi)); return r; }
typedef float f32x2 __attribute__((ext_vector_type(2)));
typedef unsigned u32x4 __attribute__((ext_vector_type(4)));
__device__ __forceinline__ float fast_sigmoid(float v) { return __builtin_amdgcn_rcpf(1.0f + __builtin_amdgcn_exp2f(-1.4426950408889634f * v)); }

struct EpiGated {
    static constexpr bool PERM = true, AFTER_DRAIN = false;
    bf16_t* O; int ldo; const float* bias_p; const float* bias_q; int swi;
    __device__ __forceinline__ void operator()(const f32x4 (&acc)[2][2][4][2], const Unit& u, int wr, int wc, int fr, int fq) const {
        const int row0 = u.pm * BM + wr * 64 + fr; const int col0 = u.pn * HALF + wc * 32 + 8 * fq;
#pragma unroll
        for (int ai = 0; ai < 2; ++ai)
#pragma unroll
            for (int m = 0; m < 4; ++m) {
                bf16_t* rowp = O + (size_t)(row0 + ai * HALF + m * 16) * ldo + col0;
                float o[8];
#pragma unroll
                for (int n = 0; n < 2; ++n) { f32x4 p = acc[ai][0][m][n], q = acc[ai][1][m][n];
                    if (bias_p) { p += *(const f32x4*)(bias_p + col0 + 4 * n); q += *(const f32x4*)(bias_q + col0 + 4 * n); }
#pragma unroll
                    for (int e = 0; e < 4; ++e) { const float s = fast_sigmoid(p[e]); o[4 * n + e] = s * q[e] * (swi ? p[e] : 1.0f); } }
                u32x4 w; w.x = cvt_pk_bf16(o[0], o[1]); w.y = cvt_pk_bf16(o[2], o[3]); w.z = cvt_pk_bf16(o[4], o[5]); w.w = cvt_pk_bf16(o[6], o[7]);
                *(u32x4*)rowp = w;
                asm volatile("" ::: "memory");
            }
    }
};

struct EpiF32 {
    static constexpr bool PERM = false, AFTER_DRAIN = false;
    float* O; int ldo; const float* bias;
    __device__ __forceinline__ void operator()(const f32x4 (&acc)[2][2][4][2], const Unit& u, int wr, int wc, int fr, int fq) const {
        const int row0 = u.pm * BM + wr * 64 + fr; const int col0 = u.pn * BM + wc * 32 + 4 * fq;
#pragma unroll
        for (int bj = 0; bj < 2; ++bj)
#pragma unroll
            for (int n = 0; n < 2; ++n) { const f32x4 bv = bias ? *(const f32x4*)(bias + col0 + bj * HALF + n * 16) : (f32x4){0.f, 0.f, 0.f, 0.f};
#pragma unroll
                for (int ai = 0; ai < 2; ++ai)
#pragma unroll
                    for (int m = 0; m < 4; ++m) *(f32x4*)(O + (size_t)(row0 + ai * HALF + m * 16) * ldo + col0 + bj * HALF + n * 16) = acc[ai][bj][m][n] + bv; }
    }
};

struct EpiRope {
    static constexpr bool PERM = true, AFTER_DRAIN = false;
    bf16_t* O; const float* tab; int seqmask;
    __device__ __forceinline__ void operator()(const f32x4 (&acc)[2][2][4][2], const Unit& u, int wr, int wc, int fr, int fq) const {
        const int row0 = u.pm * BM + wr * 64 + fr;
#pragma unroll
        for (int ai = 0; ai < 2; ++ai)
#pragma unroll
            for (int m = 0; m < 4; ++m) {
                const int row = row0 + ai * HALF + m * 16;
                bf16_t* rowp = O + (size_t)row * 1536 + u.pn * BM;
                if (u.pn < 5) {
                    const int pos = row & seqmask;
                    const float* tp = tab + ((size_t)pos * 32 + 8 * fq) * 2;
                    float o1[8], o2[8];
#pragma unroll
                    for (int n = 0; n < 2; ++n) { const f32x4 x1 = acc[ai][0][m][n], x2 = acc[ai][1][m][n];
                        const f32x4 cs0 = *(const f32x4*)(tp + 8 * n), cs1 = *(const f32x4*)(tp + 8 * n + 4);
                        const float c[4] = {cs0[0], cs0[2], cs1[0], cs1[2]}, s[4] = {cs0[1], cs0[3], cs1[1], cs1[3]};
#pragma unroll
                        for (int e = 0; e < 4; ++e) { o1[4 * n + e] = x1[e] * c[e] - x2[e] * s[e]; o2[4 * n + e] = x2[e] * c[e] + x1[e] * s[e]; } }
                    u32x4 w1, w2; w1.x = cvt_pk_bf16(o1[0], o1[1]); w1.y = cvt_pk_bf16(o1[2], o1[3]); w1.z = cvt_pk_bf16(o1[4], o1[5]); w1.w = cvt_pk_bf16(o1[6], o1[7]);
                    w2.x = cvt_pk_bf16(o2[0], o2[1]); w2.y = cvt_pk_bf16(o2[2], o2[3]); w2.z = cvt_pk_bf16(o2[4], o2[5]); w2.w = cvt_pk_bf16(o2[6], o2[7]);
                    *(u32x4*)(rowp + wc * 64 + 8 * fq) = w1; *(u32x4*)(rowp + wc * 64 + 32 + 8 * fq) = w2;
                } else {
#pragma unroll
                    for (int bj = 0; bj < 2; ++bj) { const f32x4 v0 = acc[ai][bj][m][0], v1 = acc[ai][bj][m][1];
                        u32x4 w; w.x = cvt_pk_bf16(v0[0], v0[1]); w.y = cvt_pk_bf16(v0[2], v0[3]); w.z = cvt_pk_bf16(v1[0], v1[1]); w.w = cvt_pk_bf16(v1[2], v1[3]);
                        *(u32x4*)(rowp + bj * HALF + wc * 32 + 8 * fq) = w; }
                }
                asm volatile("" ::: "memory");
            }
    }
};
template <class Epi, class Sched, bool ALIGN_EPI = false, bool SP2 = false>
__device__ __forceinline__ void gemm_phase(PG8_LAS unsigned char* lds, const Gemm g, const Sched& S, const Epi& E, const int tid) {
    const int wid = __builtin_amdgcn_readfirstlane(tid >> 6), lane = tid & 63, wr = wid >> 2, wc = wid & 3, fr = lane & 15, fq = lane >> 4;
    const int K = g.K, nt = K / BK;
    unsigned voffA[2], voffB[2];
#pragma unroll
    for (int i = 0; i < 2; ++i) { int R, C; stage_rc(tid * 16 + i * 8192, R, C); const int Rb = Epi::PERM ? ((R & ~31) + perm32(R & 31)) : R;
        voffA[i] = (unsigned)(R * K + C) * 2u; voffB[i] = (unsigned)(Rb * K + C) * 2u; }
    const size_t kstep = (size_t)(BK * 2);
    const size_t hstep = (size_t)HALF * K * 2;
    const size_t tstep = 2 * hstep;
    const unsigned ldsw = (unsigned)wid * 1024u;
    const int aoff = lds_byte(wr * 64 + fr, fq * 8), boff = lds_byte(wc * 32 + fr, fq * 8);
#define PG8_SA(b, h) (((b) * 2 + (h)) * HTB)
#define PG8_SB(b, h) ((4 + (b) * 2 + (h)) * HTB)
#define PG8_STAGE(bufoff, gbase, voff) do { _Pragma("unroll") for (int _i = 0; _i < 2; ++_i) \
        __builtin_amdgcn_global_load_lds((const unsigned*)((const char*)(gbase) + (voff)[_i]), (PG8_LAS unsigned*)(lds + (bufoff) + ldsw + _i * 8192), 16, 0, 0); } while (0)
#define PG8_LDA(dst, b, h) do { _Pragma("unroll") for (int m = 0; m < 4; ++m) _Pragma("unroll") for (int k = 0; k < 2; ++k) dst[m][k] = *(const PG8_LAS bf16x8*)(lds + PG8_SA(b, h) + aoff + m * 2048 + k * 1024); } while (0)
#define PG8_LDB(dst, b, h) do { _Pragma("unroll") for (int n = 0; n < 2; ++n) _Pragma("unroll") for (int k = 0; k < 2; ++k) dst[n][k] = *(const PG8_LAS bf16x8*)(lds + PG8_SB(b, h) + boff + n * 2048 + k * 1024); } while (0)
#define PG8_MMA(ai, bj, At, Bt) do { __builtin_amdgcn_s_setprio(1); _Pragma("unroll") for (int m = 0; m < 4; ++m) _Pragma("unroll") for (int n = 0; n < 2; ++n) _Pragma("unroll") for (int k = 0; k < 2; ++k) \
        acc[ai][bj][m][n] = __builtin_amdgcn_mfma_f32_16x16x32_bf16(Bt[n][k], At[m][k], acc[ai][bj][m][n], 0, 0, 0); __builtin_amdgcn_s_setprio(0); } while (0)
#define PG8_WAIT_V(n) asm volatile("s_waitcnt vmcnt(" #n ")" ::: "memory")
#define PG8_WAIT_L(n) asm volatile("s_waitcnt lgkmcnt(" #n ")" ::: "memory")
#define PG8_BAR __builtin_amdgcn_s_barrier()
#define PG8_SCHED __builtin_amdgcn_sched_barrier(0)
    Unit cur, nxt; int ui = 0;
    if (!S.next(0, cur)) return;
    f32x4 acc[2][2][4][2];
#pragma unroll
    for (int a = 0; a < 2; ++a)
#pragma unroll
        for (int b = 0; b < 2; ++b)
#pragma unroll
            for (int m = 0; m < 4; ++m)
#pragma unroll
                for (int n = 0; n < 2; ++n) acc[a][b][m][n] = (f32x4){0.f, 0.f, 0.f, 0.f};
    bf16x8 At[4][2], B0[2][2], B1[2][2];
    const char* cA = (const char*)g.A + (size_t)cur.pm * tstep; const char* cB = (const char*)g.Bt + (size_t)cur.pn * tstep;
    S.a_ready(cur);
    if constexpr (SP2) {
        PG8_STAGE(PG8_SB(0, 0), cB, voffB); PG8_STAGE(PG8_SB(0, 1), cB + hstep, voffB); PG8_STAGE(PG8_SA(0, 0), cA, voffA); PG8_STAGE(PG8_SA(0, 1), cA + hstep, voffA);
        if (wr == 1) PG8_BAR;
        PG8_WAIT_V(2); PG8_BAR;
        PG8_STAGE(PG8_SB(1, 0), cB + kstep, voffB); PG8_STAGE(PG8_SA(1, 0), cA + kstep, voffA); PG8_STAGE(PG8_SB(1, 1), cB + hstep + kstep, voffB);
        PG8_WAIT_V(6); PG8_BAR;
    } else {
        PG8_STAGE(PG8_SB(0, 0), cB, voffB); PG8_STAGE(PG8_SA(0, 0), cA, voffA); PG8_STAGE(PG8_SB(0, 1), cB + hstep, voffB); PG8_STAGE(PG8_SA(0, 1), cA + hstep, voffA);
        if (wr == 1) PG8_BAR;
        PG8_WAIT_V(4); PG8_BAR;
        PG8_STAGE(PG8_SB(1, 0), cB + kstep, voffB); PG8_STAGE(PG8_SA(1, 0), cA + kstep, voffA); PG8_STAGE(PG8_SB(1, 1), cB + hstep + kstep, voffB);
        PG8_WAIT_V(6); PG8_BAR;
    }
    for (;;) {
        const bool has_next = S.next(ui + 1, nxt);
        const char* nA = has_next ? (const char*)g.A + (size_t)nxt.pm * tstep : cA; const char* nB = has_next ? (const char*)g.Bt + (size_t)nxt.pn * tstep : cB;
        for (int t = 0; t < nt; t += 2) {
            const bool last = (t == nt - 2);
            const char* a1 = cA + (size_t)(t + 1) * kstep;
            const char* a2 = last ? nA : cA + (size_t)(t + 2) * kstep; const char* b2 = last ? nB : cB + (size_t)(t + 2) * kstep;
            const char* a3 = a2 + kstep; const char* b3 = b2 + kstep;
            if (last && has_next) S.a_ready(nxt);
            if constexpr (SP2) {
            PG8_LDB(B0, 0, 0); PG8_LDB(B1, 0, 1); PG8_SCHED; PG8_LDA(At, 0, 0); PG8_STAGE(PG8_SA(1, 1), a1 + hstep, voffA);
            PG8_WAIT_V(8); PG8_WAIT_L(0); PG8_BAR; PG8_MMA(0, 0, At, B0); PG8_MMA(0, 1, At, B1); PG8_BAR; PG8_SCHED;
            PG8_LDA(At, 0, 1); PG8_STAGE(PG8_SB(0, 0), b2, voffB); PG8_STAGE(PG8_SB(0, 1), b2 + hstep, voffB); PG8_STAGE(PG8_SA(0, 0), a2, voffA);
            PG8_WAIT_V(8); PG8_WAIT_L(0); PG8_BAR; PG8_MMA(1, 0, At, B0); PG8_MMA(1, 1, At, B1); PG8_BAR; PG8_SCHED;
            PG8_LDB(B0, 1, 0); PG8_LDB(B1, 1, 1); PG8_SCHED; PG8_LDA(At, 1, 0); PG8_STAGE(PG8_SA(0, 1), a2 + hstep, voffA);
            PG8_WAIT_V(8); PG8_WAIT_L(0); PG8_BAR; PG8_MMA(0, 0, At, B0); PG8_MMA(0, 1, At, B1); PG8_BAR; PG8_SCHED;
            PG8_LDA(At, 1, 1); PG8_STAGE(PG8_SB(1, 0), b3, voffB); PG8_STAGE(PG8_SB(1, 1), b3 + hstep, voffB); PG8_STAGE(PG8_SA(1, 0), a3, voffA);
            PG8_WAIT_V(8); PG8_WAIT_L(0); PG8_BAR; PG8_MMA(1, 0, At, B0); PG8_MMA(1, 1, At, B1); PG8_BAR; PG8_SCHED;
            } else {
            PG8_LDB(B0, 0, 0); PG8_SCHED; PG8_LDA(At, 0, 0); PG8_STAGE(PG8_SA(1, 1), a1 + hstep, voffA);
            PG8_WAIT_L(8); PG8_BAR; PG8_WAIT_L(0); PG8_MMA(0, 0, At, B0); PG8_BAR; PG8_SCHED;
            PG8_LDB(B1, 0, 1); PG8_STAGE(PG8_SB(0, 0), b2, voffB);
            PG8_BAR; PG8_WAIT_L(0); PG8_MMA(0, 1, At, B1); PG8_BAR;
            PG8_LDA(At, 0, 1); PG8_STAGE(PG8_SA(0, 0), a2, voffA);
            PG8_BAR; PG8_WAIT_L(0); PG8_MMA(1, 0, At, B0); PG8_BAR; PG8_SCHED;
            PG8_STAGE(PG8_SB(0, 1), b2 + hstep, voffB);
            PG8_WAIT_V(6); PG8_BAR; PG8_MMA(1, 1, At, B1); PG8_BAR;
            PG8_LDB(B0, 1, 0); PG8_SCHED; PG8_LDA(At, 1, 0); PG8_STAGE(PG8_SA(0, 1), a2 + hstep, voffA);
            PG8_WAIT_L(8); PG8_BAR; PG8_WAIT_L(0); PG8_MMA(0, 0, At, B0); PG8_BAR; PG8_SCHED;
            PG8_LDB(B1, 1, 1); PG8_STAGE(PG8_SB(1, 0), b3, voffB);
            PG8_BAR; PG8_WAIT_L(0); PG8_MMA(0, 1, At, B1); PG8_BAR;
            PG8_LDA(At, 1, 1); PG8_STAGE(PG8_SA(1, 0), a3, voffA);
            PG8_BAR; PG8_WAIT_L(0); PG8_MMA(1, 0, At, B0); PG8_BAR; PG8_SCHED;
            PG8_STAGE(PG8_SB(1, 1), b3 + hstep, voffB);
            PG8_WAIT_V(6); PG8_BAR; PG8_MMA(1, 1, At, B1); PG8_BAR;
            }
        }
        if constexpr (ALIGN_EPI) { if (wr == 0) PG8_BAR; }
        if constexpr (!Epi::AFTER_DRAIN) { E(acc, cur, wr, wc, fr, fq); S.done(cur); }
        if (!has_next) break;
#pragma unroll
        for (int a = 0; a < 2; ++a)
#pragma unroll
            for (int b = 0; b < 2; ++b)
#pragma unroll
                for (int m = 0; m < 4; ++m)
#pragma unroll
                    for (int n = 0; n < 2; ++n) acc[a][b][m][n] = (f32x4){0.f, 0.f, 0.f, 0.f};
        cur = nxt; cA = nA; cB = nB; ++ui;
        if constexpr (ALIGN_EPI) { if (wr == 1) PG8_BAR; }
    }
    PG8_WAIT_V(0);
    if constexpr (!ALIGN_EPI) { if (wr == 0) PG8_BAR; }
    PG8_BAR;
    if constexpr (Epi::AFTER_DRAIN) { E.fused(acc, cur, wr, wc, fr, fq, lds, wid, lane); S.done(cur); }
#undef PG8_SA
#undef PG8_SB
#undef PG8_STAGE
#undef PG8_LDA
#undef PG8_LDB
#undef PG8_MMA
#undef PG8_WAIT_V
#undef PG8_WAIT_L
#undef PG8_BAR
#undef PG8_SCHED
}
}
#define LAS __attribute__((address_space(3)))
typedef unsigned short bf16;
typedef unsigned v4u __attribute__((ext_vector_type(4)));
typedef unsigned v2u __attribute__((ext_vector_type(2)));
typedef float f32x4 __attribute__((ext_vector_type(4)));
typedef float f32x2 __attribute__((ext_vector_type(2)));
typedef float f32x16 __attribute__((ext_vector_type(16)));
typedef short bf16x8 __attribute__((ext_vector_type(8)));
typedef short s16x4 __attribute__((ext_vector_type(4)));
typedef __bf16 bf16x2_t __attribute__((ext_vector_type(2)));

constexpr int NWAVES = 8, NTHREADS = 512;
constexpr int D = 1024, FF = 4096, MH = 16384  , NQKV = 1536;
constexpr float EPS = 1e-6f;
constexpr size_t MiB = 1u << 20;
constexpr size_t WS_CTL = 0;
constexpr size_t WS_WGU = 1 * MiB;
constexpr size_t WS_WD = 65 * MiB;
constexpr size_t WS_WPW1 = 97 * MiB;
constexpr size_t WS_WPW2 = 101 * MiB;
constexpr size_t WS_WQKV = 103 * MiB;
constexpr size_t WS_WO = 106 * MiB;
constexpr size_t WS_ROPE = 108 * MiB;
constexpr size_t WS_HN = 110 * MiB;
constexpr size_t WS_ACT = 142 * MiB;
constexpr size_t WS_H = 270 * MiB;
constexpr size_t WS_END = 334 * MiB;
constexpr size_t ACT_GLU = 0, ACT_CV = 32 * MiB, ACT_QKV = 0, ACT_AO = 64 * MiB;

constexpr int RING_BYTES = 131072;
constexpr int LDS_BYTES = 147456;

__device__ __forceinline__ unsigned f2bf(float f) { unsigned u = __builtin_bit_cast(unsigned, f); return (u + 0x7fffu + ((u >> 16) & 1u)) >> 16; }
__device__ __forceinline__ unsigned pk2(float lo, float hi) { f32x2 v = {lo, hi}; bf16x2_t b = __builtin_convertvector(v, bf16x2_t); return __builtin_bit_cast(unsigned, b); }
__device__ __forceinline__ float bf_lo(unsigned w) { return __builtin_bit_cast(float, w << 16); }
__device__ __forceinline__ float bf_hi(unsigned w) { return __builtin_bit_cast(float, w & 0xffff0000u); }
__device__ __forceinline__ float wave_sum(float v) {
#pragma unroll
    for (int o = 1; o < 64; o <<= 1) v += __shfl_xor(v, o);
    return v;
}

struct Params {
    const float* x_in[2];
    const float* norm_g; const float* w_gate; const float* w_up; const float* w_down;
    const float* pw1; const float* b_pw1; const float* w_dw; const float* b_dw; const float* ln_g; const float* ln_b; const float* pw2; const float* b_pw2;
    const float* w_qkv; const float* w_o; const float* sink;
    float* out; unsigned char* ws;
};

__device__ const float ROPE_INV[32] = {1.000000000e+00f, 7.498942614e-01f, 5.623413324e-01f, 4.216965139e-01f, 3.162277639e-01f, 2.371373773e-01f, 1.778279394e-01f, 1.333521307e-01f, 1.000000015e-01f, 7.498941571e-02f, 5.623413250e-02f, 4.216965288e-02f, 3.162277490e-02f, 2.371373773e-02f, 1.778279431e-02f, 1.333521493e-02f, 9.999999776e-03f, 7.498941850e-03f, 5.623413250e-03f, 4.216964822e-03f, 3.162277630e-03f, 2.371373586e-03f, 1.778279431e-03f, 1.333521446e-03f, 1.000000047e-03f, 7.498942432e-04f, 5.623413017e-04f, 4.216965172e-04f, 3.162277571e-04f, 2.371373703e-04f, 1.778279402e-04f, 1.333521504e-04f};

__device__ __forceinline__ void transpose_item(const float* src  , int ldn, int k0, bf16* dstrow0  , int K, LAS float* scr, int lane) {
#pragma unroll 8
    for (int i = 0; i < 32; ++i) { const int kk = 2 * i + (lane >> 5); scr[kk * 33 + (lane & 31)] = src[(size_t)(k0 + kk) * ldn + (lane & 31)]; }
    asm volatile("s_waitcnt lgkmcnt(0)" ::: "memory");
    const int c = lane & 7;
#pragma unroll
    for (int j = 0; j < 4; ++j) { const int n = (lane >> 3) + 8 * j; const LAS float* s = scr + (8 * c) * 33 + n;
        v4u o; o.x = pk2(s[0 * 33], s[1 * 33]); o.y = pk2(s[2 * 33], s[3 * 33]); o.z = pk2(s[4 * 33], s[5 * 33]); o.w = pk2(s[6 * 33], s[7 * 33]);
        *(v4u*)(dstrow0 + (size_t)n * K + k0 + 8 * c) = o; }
    asm volatile("s_waitcnt lgkmcnt(0)" ::: "memory");
}

__device__ __forceinline__ void prologue(const Params& P, LAS unsigned char* lds, int gw, int NGW, int lane, int wave) {
    LAS float* scr = (LAS float*)(lds + wave * 16384);
    unsigned char* ws = P.ws;
    constexpr int I_GU = (D / 64) * (2 * FF / 32);
    constexpr int I_D = (FF / 64) * (D / 32);
    constexpr int I_PW1 = (D / 64) * (2 * D / 32);
    constexpr int I_SQ = (D / 64) * (D / 32);
    constexpr int I_QKV = (D / 64) * (NQKV / 32);
    constexpr int NITEMS = 4 * I_GU + 4 * I_D + I_PW1 + I_SQ + I_QKV + I_SQ;
    for (int it = gw; it < NITEMS; it += NGW) {
        int r = it;
        if (r < 4 * I_GU) { const int f = r / I_GU; r -= f * I_GU; const int nblk = 2 * FF / 32, kb = r / nblk, nb = r % nblk; const int n0 = nb * 32, tile = n0 >> 8, within = n0 & 255;
            const float* W = (within < 128 ? P.w_gate : P.w_up) + (size_t)f * D * FF + tile * 128 + (within & 127);
            transpose_item(W, FF, kb * 64, (bf16*)(ws + WS_WGU) + (size_t)f * 2 * FF * D + (size_t)n0 * D, D, scr, lane); continue; }
        r -= 4 * I_GU;
        if (r < 4 * I_D) { const int f = r / I_D; r -= f * I_D; const int nblk = D / 32, kb = r / nblk, nb = r % nblk; const int n0 = nb * 32;
            transpose_item(P.w_down + (size_t)f * FF * D + n0, D, kb * 64, (bf16*)(ws + WS_WD) + (size_t)f * D * FF + (size_t)n0 * FF, FF, scr, lane); continue; }
        r -= 4 * I_D;
        if (r < I_PW1) { const int nblk = 2 * D / 32, kb = r / nblk, nb = r % nblk; const int n0 = nb * 32, tile = n0 >> 8, within = n0 & 255;
            const float* W = P.pw1 + (within < 128 ? 1024 : 0) + tile * 128 + (within & 127);
            transpose_item(W, 2 * D, kb * 64, (bf16*)(ws + WS_WPW1) + (size_t)n0 * D, D, scr, lane); continue; }
        r -= I_PW1;
        if (r < I_SQ) { const int nblk = D / 32, kb = r / nblk, nb = r % nblk; const int n0 = nb * 32;
            transpose_item(P.pw2 + n0, D, kb * 64, (bf16*)(ws + WS_WPW2) + (size_t)n0 * D, D, scr, lane); continue; }
        r -= I_SQ;
        if (r < I_QKV) { const int nblk = NQKV / 32, kb = r / nblk, nb = r % nblk; const int n0 = nb * 32, tile = n0 >> 8, within = n0 & 255;
            const int col = (tile < 5) ? tile * 256 + ((within & 127) >> 5) * 64 + (within >> 7) * 32 : n0;
            transpose_item(P.w_qkv + col, NQKV, kb * 64, (bf16*)(ws + WS_WQKV) + (size_t)n0 * D, D, scr, lane); continue; }
        r -= I_QKV;
        { const int nblk = D / 32, kb = r / nblk, nb = r % nblk; const int n0 = nb * 32;
            transpose_item(P.w_o + n0, D, kb * 64, (bf16*)(ws + WS_WO) + (size_t)n0 * D, D, scr, lane); }
    }
    { f32x2* tab = (f32x2*)(ws + WS_ROPE);
      for (int e = gw * 64 + lane; e < 8192 * 32; e += NGW * 64) { const int pos = e >> 5, i = e & 31;
          const float ang = (float)pos * ROPE_INV[i];
          const double rev = (double)ang * 0.15915494309189535; const float fr = (float)(rev - __builtin_floor(rev));
          tab[e] = (f32x2){__builtin_amdgcn_cosf(fr), __builtin_amdgcn_sinf(fr)}; } }
}

__device__ __forceinline__ void rms_rows_to_bf16(const float* x, const float* g, bf16* hn, int nrows, int gw, int NGW, int lane) {
    for (int row = gw; row < nrows; row += NGW) {
        const f32x4* xr = (const f32x4*)(x + (size_t)row * D) + lane; f32x4 v[4]; float ss = 0.f;
#pragma unroll
        for (int j = 0; j < 4; ++j) { v[j] = xr[64 * j]; ss += (v[j].x * v[j].x + v[j].y * v[j].y) + (v[j].z * v[j].z + v[j].w * v[j].w); }
        const float rstd = 1.0f / sqrtf(wave_sum(ss) * (1.f / D) + EPS);
        v2u* o = (v2u*)(hn + (size_t)row * D) + lane;
#pragma unroll
        for (int j = 0; j < 4; ++j) { const f32x4 gg = ((const f32x4*)g)[64 * j + lane]; v2u w; w.x = pk2(v[j].x * rstd * gg.x, v[j].y * rstd * gg.y); w.y = pk2(v[j].z * rstd * gg.z, v[j].w * rstd * gg.w); o[64 * j] = w; }
    }
}
__device__ __forceinline__ void row_phase(const float* h, const float* base, float* out, float coef, const float* g_post, const float* g_pre, bf16* hn, int gw, int NGW, int lane) {
    for (int row = gw; row < MH; row += NGW) {
        const f32x4* hr = (const f32x4*)(h + (size_t)row * D) + lane; const f32x4* br = (const f32x4*)(base + (size_t)row * D) + lane;
        f32x4 v[4], b[4]; float ss = 0.f;
#pragma unroll
        for (int j = 0; j < 4; ++j) { v[j] = hr[64 * j]; b[j] = br[64 * j]; ss += (v[j].x * v[j].x + v[j].y * v[j].y) + (v[j].z * v[j].z + v[j].w * v[j].w); }
        const float rstd = coef / sqrtf(wave_sum(ss) * (1.f / D) + EPS);
        f32x4* orow = (f32x4*)(out + (size_t)row * D) + lane; float s2 = 0.f;
#pragma unroll
        for (int j = 0; j < 4; ++j) { const f32x4 gg = ((const f32x4*)g_post)[64 * j + lane]; v[j] = b[j] + v[j] * rstd * gg; orow[64 * j] = v[j];
            s2 += (v[j].x * v[j].x + v[j].y * v[j].y) + (v[j].z * v[j].z + v[j].w * v[j].w); }
        if (g_pre) {
            const float r2 = 1.0f / sqrtf(wave_sum(s2) * (1.f / D) + EPS);
            v2u* o = (v2u*)(hn + (size_t)row * D) + lane;
#pragma unroll
            for (int j = 0; j < 4; ++j) { const f32x4 gg = ((const f32x4*)g_pre)[64 * j + lane]; v2u w; w.x = pk2(v[j].x * r2 * gg.x, v[j].y * r2 * gg.y); w.y = pk2(v[j].z * r2 * gg.z, v[j].w * r2 * gg.w); o[64 * j] = w; }
        }
    }
}

__device__ __forceinline__ void conv_phase(const Params& P, LAS unsigned char* lds, const bf16* glu, bf16* cv, int S, int vcu, int G, int tid, int lane, int wave) {
    const int c0 = 2 * tid;
    f32x2 w[31];
#pragma unroll
    for (int k = 0; k < 31; ++k) w[k] = *(const f32x2*)(P.w_dw + k * D + c0);
    const f32x2 bdw = *(const f32x2*)(P.b_dw + c0), lg = *(const f32x2*)(P.ln_g + c0), lb = *(const f32x2*)(P.ln_b + c0);
    LAS float* part = (LAS float*)lds;
    LAS float* tot = (LAS float*)(lds + 2048);
    for (int u = vcu; u < MH / 32; u += G) {
        const int row0 = u * 32, s0 = row0 & (S - 1);
        f32x2 acc[32];
#pragma unroll
        for (int r = 0; r < 32; ++r) acc[r] = bdw;
#pragma clang loop unroll(full)
        for (int i = 0; i < 62; ++i) {
            const int sp = s0 - 15 + i;
            unsigned wv = 0u;
            if (sp >= 0 && sp < S) wv = *(const unsigned*)(glu + (size_t)(row0 - 15 + i) * D + c0);
            const f32x2 xv = {bf_lo(wv), bf_hi(wv)};
#pragma unroll
            for (int r = 0; r < 32; ++r) { const int k = i - r; if (k >= 0 && k < 31) acc[r] += w[k] * xv; }
        }
        float v[64];
#pragma unroll
        for (int r = 0; r < 32; ++r) { v[2 * r] = acc[r].x + acc[r].y; v[2 * r + 1] = acc[r].x * acc[r].x + acc[r].y * acc[r].y; }
#define TR_STEP(OFF) { const bool up = (lane & OFF) != 0; _Pragma("unroll") for (int j = 0; j < OFF; ++j) { const float send = up ? v[j] : v[j + OFF]; const float keep = up ? v[j + OFF] : v[j]; v[j] = keep + __shfl_xor(send, OFF); } }
        TR_STEP(32) TR_STEP(16) TR_STEP(8) TR_STEP(4) TR_STEP(2) TR_STEP(1)
#undef TR_STEP
        part[wave * 64 + lane] = v[0];
        __syncthreads();
        if (tid < 64) { float s = 0.f;
#pragma unroll
            for (int q = 0; q < 8; ++q) s += part[q * 64 + tid];
            tot[tid] = s; }
        __syncthreads();
#pragma unroll
        for (int r = 0; r < 32; ++r) {
            const float mean = tot[2 * r] * (1.f / D); const float var = tot[2 * r + 1] * (1.f / D) - mean * mean; const float rstd = 1.0f / sqrtf(var + EPS);
            const float y0 = (acc[r].x - mean) * rstd * lg.x + lb.x, y1 = (acc[r].y - mean) * rstd * lg.y + lb.y;
            const float o0 = y0 * pg8::fast_sigmoid(y0), o1 = y1 * pg8::fast_sigmoid(y1);
            *(unsigned*)(cv + (size_t)(row0 + r) * D + c0) = pk2(o0, o1);
        }
        __syncthreads();
    }
}

constexpr int KV_PITCH = 144, ATT_K = 0, ATT_V = 384 * KV_PITCH, ATT_SCR = 2 * 384 * KV_PITCH;
__device__ __forceinline__ int crow(int r, int hi) { return (r & 3) + 8 * (r >> 2) + 4 * hi; }
__device__ __forceinline__ s16x4 vtr(const LAS unsigned char* p) { return __builtin_bit_cast(s16x4, __builtin_amdgcn_ds_read_tr16_b64_v4i16((LAS s16x4*)p)); }
__device__ __forceinline__ void attn_phase(const Params& P, LAS unsigned char* lds, const bf16* qkv, bf16* ao, int S, int vcu, int G, int tid, int lane, int wave) {
    const int nqb = S / 128, r32 = lane & 31, hi = lane >> 5;
    const int i16 = lane & 15, tq = i16 >> 2, tp = i16 & 3, blk = (lane >> 4) & 1;
    LAS float* wsf = (LAS float*)(lds + ATT_SCR) + wave * 32;
    const float C2 = 0.125f * 1.4426950408889634f, L2E = 1.4426950408889634f;
    for (int u = vcu; u < (MH / 128) * 4; u += G) {
        const int qb = u % nqb, kvh = (u / nqb) & 3, sq = u / (nqb * 4);
        const int rowbase = sq * S, blk0 = qb * 128, win0 = blk0 - 128;
        __syncthreads();
#pragma unroll
        for (int it = 0; it < 6; ++it) { const int c = tid + it * NTHREADS, row = c >> 3, ch = c & 7; const int sp = win0 + row;
            v4u kk = {0u, 0u, 0u, 0u}, vv = {0u, 0u, 0u, 0u};
            if (sp >= 0 && sp < S) { const bf16* src = qkv + (size_t)(rowbase + sp) * NQKV + 1024 + kvh * 64 + ch * 8; kk = *(const v4u*)src; vv = *(const v4u*)(src + 256); }
            *(LAS v4u*)(lds + ATT_K + row * KV_PITCH + ch * 16) = kk; *(LAS v4u*)(lds + ATT_V + row * KV_PITCH + ch * 16) = vv; }
        __syncthreads();
#pragma unroll 1
        for (int task = wave; task < 16; task += 8) {
            const int g = task >> 2, sb = task & 3, head = kvh * 4 + g, q0 = blk0 + 32 * sb;
            bf16x8 qf[4];
            { const bf16* qp = qkv + (size_t)(rowbase + q0 + r32) * NQKV + head * 64 + 8 * hi;
#pragma unroll
              for (int ks = 0; ks < 4; ++ks) qf[ks] = *(const bf16x8*)(qp + 16 * ks); }
            f32x16 p[9];
            const LAS unsigned char* kb = lds + ATT_K + (32 * sb + r32) * KV_PITCH + 16 * hi;
#pragma unroll
            for (int t = 0; t < 9; ++t) {
                f32x16 a = {0.f, 0.f, 0.f, 0.f, 0.f, 0.f, 0.f, 0.f, 0.f, 0.f, 0.f, 0.f, 0.f, 0.f, 0.f, 0.f};
#pragma unroll
                for (int ks = 0; ks < 4; ++ks) { const bf16x8 kf = *(const LAS bf16x8*)(kb + t * 32 * KV_PITCH + 32 * ks); a = __builtin_amdgcn_mfma_f32_32x32x16_bf16(kf, qf[ks], a, 0, 0, 0); }
                const int kstart = win0 + 32 * sb + 32 * t; const bool tv = (kstart >= 0) && (kstart < S);
#pragma unroll
                for (int i = 0; i < 16; ++i) { bool ok = tv; if (t == 0) ok = ok && (crow(i, hi) >= r32); if (t == 8) ok = ok && (crow(i, hi) <= r32); a[i] = ok ? a[i] : -1e30f; }
                p[t] = a;
            }
            float m = -1e30f;
#pragma unroll
            for (int t = 0; t < 9; ++t)
#pragma unroll
                for (int i = 0; i < 16; ++i) m = fmaxf(m, p[t][i]);
            m = fmaxf(m, __shfl_xor(m, 32));
            const float sk = P.sink[head];
            const float Mx = fmaxf(m * 0.125f, sk);
            const float ML = Mx * L2E;
            float l = 0.f;
#pragma unroll
            for (int t = 0; t < 9; ++t)
#pragma unroll
                for (int i = 0; i < 16; ++i) { const float e = __builtin_amdgcn_exp2f(p[t][i] * C2 - ML); p[t][i] = e; l += e; }
            l += __shfl_xor(l, 32);
            l += __builtin_amdgcn_exp2f((sk - Mx) * L2E);
            if (hi == 0) wsf[r32] = 1.0f / l;
            f32x16 o0 = {0.f, 0.f, 0.f, 0.f, 0.f, 0.f, 0.f, 0.f, 0.f, 0.f, 0.f, 0.f, 0.f, 0.f, 0.f, 0.f}, o1 = o0;
            const LAS unsigned char* vb = lds + ATT_V + (32 * sb + 4 * hi + tq) * KV_PITCH + 32 * blk + 8 * tp;
#pragma unroll
            for (int t = 0; t < 9; ++t)
#pragma unroll
                for (int s = 0; s < 2; ++s) {
                    v4u pw; pw.x = pk2(p[t][8 * s + 0], p[t][8 * s + 1]); pw.y = pk2(p[t][8 * s + 2], p[t][8 * s + 3]); pw.z = pk2(p[t][8 * s + 4], p[t][8 * s + 5]); pw.w = pk2(p[t][8 * s + 6], p[t][8 * s + 7]);
                    const bf16x8 pa = __builtin_bit_cast(bf16x8, pw);
                    const LAS unsigned char* vp = vb + (t * 32 + 16 * s) * KV_PITCH;
                    const s16x4 l0 = vtr(vp), h0 = vtr(vp + 8 * KV_PITCH), l1 = vtr(vp + 64), h1 = vtr(vp + 64 + 8 * KV_PITCH);
                    const bf16x8 v0 = __builtin_shufflevector(l0, h0, 0, 1, 2, 3, 4, 5, 6, 7), v1 = __builtin_shufflevector(l1, h1, 0, 1, 2, 3, 4, 5, 6, 7);
                    o0 = __builtin_amdgcn_mfma_f32_32x32x16_bf16(pa, v0, o0, 0, 0, 0);
                    o1 = __builtin_amdgcn_mfma_f32_32x32x16_bf16(pa, v1, o1, 0, 0, 0);
                }
            asm volatile("s_waitcnt lgkmcnt(0)" ::: "memory");
            bf16* op = ao + (size_t)(rowbase + q0) * D + head * 64 + r32;
#pragma unroll
            for (int i = 0; i < 16; ++i) { const int qr = crow(i, hi); const float inv = wsf[qr];
                op[(size_t)qr * D] = (bf16)f2bf(o0[i] * inv); op[(size_t)qr * D + 32] = (bf16)f2bf(o1[i] * inv); }
            asm volatile("s_waitcnt lgkmcnt(0)" ::: "memory");
        }
    }
}

enum { OP_GU = 0, OP_F32 = 1, OP_ROW = 2, OP_PW1 = 3, OP_CONV = 4, OP_QKV = 5, OP_ATT = 6 };
constexpr int STEPS_PER_HALF = 20;

__global__ void __launch_bounds__(NTHREADS, 2) mega_fwd(Params P) {
    extern __shared__ __attribute__((aligned(16))) unsigned char lds_raw[];
    cg::grid_group grid = cg::this_grid();
    LAS unsigned char* lds = (LAS unsigned char*)lds_raw;
    const int wave = __builtin_amdgcn_readfirstlane(threadIdx.x >> 6);
    const int G = gridDim.x, bx = blockIdx.x;
    const int vcu = (G % 8 == 0) ? (bx % 8) * (G / 8) + bx / 8 : bx;
    const int gw = vcu * NWAVES + wave, NGW = G * NWAVES;
    unsigned char* ws = P.ws;
    bf16* HN = (bf16*)(ws + WS_HN);
    float* H = (float*)(ws + WS_H);

    { int tid0 = threadIdx.x; asm volatile("" : "+v"(tid0)); const int lane = tid0 & 63;
      prologue(P, lds, gw, NGW, lane, wave);
      rms_rows_to_bf16(P.x_in[0], P.norm_g, HN, MH, gw, NGW, lane); }
    grid.sync();

    for (int step = 0; step < 2 * STEPS_PER_HALF; ++step) {
        int tidl = threadIdx.x; asm volatile("" : "+v"(tidl));
        const int tid = tidl, lane = tidl & 63;
        const int hf = step / STEPS_PER_HALF, s = step % STEPS_PER_HALF;
        const int S = hf ? 8192 : 4096;
        float* xout = P.out + (size_t)hf * MH * D;
        const int layer = s / 10, ls = s % 10;
        int op;
        if (ls == 0 || ls == 7) op = OP_GU; else if (ls == 1 || ls == 5 || ls == 8) op = OP_F32; else if (ls == 2 || ls == 6 || ls == 9) op = OP_ROW;
        else if (ls == 3) op = layer ? OP_QKV : OP_PW1; else op = layer ? OP_ATT : OP_CONV;
        const int f = layer * 2 + (ls >= 7 ? 1 : 0);
        if (op == OP_GU) {
            pg8::Gemm g{HN, (const bf16*)(ws + WS_WGU) + (size_t)f * 2 * FF * D, MH, 2 * FF, D}; pg8::StaticOrder So; So.init(MH, 2 * FF, G, bx);
            pg8::EpiGated E{(bf16*)(ws + WS_ACT), FF, nullptr, nullptr, 1};
#ifndef NO_GU
            pg8::gemm_phase<pg8::EpiGated, pg8::StaticOrder, true, true>(lds, g, So, E, tidl);
#endif
        } else if (op == OP_PW1) {
            pg8::Gemm g{HN, (const bf16*)(ws + WS_WPW1), MH, 2 * D, D}; pg8::StaticOrder So; So.init(MH, 2 * D, G, bx);
            pg8::EpiGated E{(bf16*)(ws + WS_ACT + ACT_GLU), D, P.b_pw1 + 1024, P.b_pw1, 0};
#ifndef NO_PW1
            pg8::gemm_phase<pg8::EpiGated, pg8::StaticOrder, true, true>(lds, g, So, E, tidl);
#endif
        } else if (op == OP_F32) {
            const bf16* A; const bf16* B; int K; const float* bias = nullptr;
            if (ls == 1 || ls == 8) { A = (const bf16*)(ws + WS_ACT); B = (const bf16*)(ws + WS_WD) + (size_t)f * D * FF; K = FF; }
            else if (layer == 0) { A = (const bf16*)(ws + WS_ACT + ACT_CV); B = (const bf16*)(ws + WS_WPW2); K = D; bias = P.b_pw2; }
            else { A = (const bf16*)(ws + WS_ACT + ACT_AO); B = (const bf16*)(ws + WS_WO); K = D; }
            pg8::Gemm g{A, B, MH, D, K}; pg8::StaticOrder So; So.init(MH, D, G, bx);
            pg8::EpiF32 E{H, D, bias};
#ifndef NO_F32
            pg8::gemm_phase<pg8::EpiF32, pg8::StaticOrder, true, true>(lds, g, So, E, tidl);
#endif
        } else if (op == OP_QKV) {
            pg8::Gemm g{HN, (const bf16*)(ws + WS_WQKV), MH, NQKV, D}; pg8::StaticOrder So; So.init(MH, NQKV, G, bx);
            pg8::EpiRope E{(bf16*)(ws + WS_ACT + ACT_QKV), (const float*)(ws + WS_ROPE), S - 1};
#ifndef NO_QKV
            pg8::gemm_phase<pg8::EpiRope, pg8::StaticOrder, true, true>(lds, g, So, E, tidl);
#endif
        } else if (op == OP_CONV) {

#ifndef NO_CONV
            conv_phase(P, lds, (const bf16*)(ws + WS_ACT + ACT_GLU), (bf16*)(ws + WS_ACT + ACT_CV), S, vcu, G, tid, lane, wave);
#endif
        } else if (op == OP_ATT) {
#ifndef NO_ATT
            attn_phase(P, lds, (const bf16*)(ws + WS_ACT + ACT_QKV), (bf16*)(ws + WS_ACT + ACT_AO), S, vcu, G, tid, lane, wave);
#endif
        } else {
            const int j = (ls == 2) ? 1 : (ls == 6 ? 3 : 5);
            const float* g_post = P.norm_g + (size_t)(layer * 6 + j) * D;
            const bool last = (s == STEPS_PER_HALF - 1);
            const float* g_pre = last ? nullptr : P.norm_g + (size_t)(layer * 6 + j + 1) * D;
            const float* base = (s == 2) ? (hf ? P.x_in[1] : P.x_in[0]) : xout;
            row_phase(H, base, xout, (j == 3) ? 1.0f : 0.5f, g_post, g_pre, HN, gw, NGW, lane);
            if (last && hf == 0) rms_rows_to_bf16(P.x_in[1], P.norm_g, HN, MH, gw, NGW, lane);
        }
        grid.sync();
    }
}

extern "C" void kernel_launch(void* const* d_in, const int* in_sizes, int n_in, void* d_out, int out_size, void* d_ws, size_t ws_size, hipStream_t stream) {
    static int grid_blocks = 0;
    if (grid_blocks == 0) {
        if (ws_size < WS_END) { fprintf(stderr, "kernel_launch: workspace too small: %zu < %zu\n", ws_size, (size_t)WS_END); grid_blocks = -1; return; }
        int dev = 0, cus = 0, per_cu = 0;
        hipGetDevice(&dev);
        hipDeviceGetAttribute(&cus, hipDeviceAttributeMultiprocessorCount, dev);
        hipFuncSetAttribute((const void*)mega_fwd, hipFuncAttributeMaxDynamicSharedMemorySize, LDS_BYTES);
        hipOccupancyMaxActiveBlocksPerMultiprocessor(&per_cu, (const void*)mega_fwd, NTHREADS, LDS_BYTES);
        if (per_cu < 1) per_cu = 1;
        grid_blocks = cus * per_cu;
        (void)hipGetLastError();
    }
    if (grid_blocks < 0) return;
    Params p{};
    p.x_in[0] = (const float*)d_in[0]; p.x_in[1] = (const float*)d_in[1];
    p.norm_g = (const float*)d_in[2]; p.w_gate = (const float*)d_in[3]; p.w_up = (const float*)d_in[4]; p.w_down = (const float*)d_in[5];
    p.pw1 = (const float*)d_in[6]; p.b_pw1 = (const float*)d_in[7]; p.w_dw = (const float*)d_in[8]; p.b_dw = (const float*)d_in[9];
    p.ln_g = (const float*)d_in[10]; p.ln_b = (const float*)d_in[11]; p.pw2 = (const float*)d_in[12]; p.b_pw2 = (const float*)d_in[13];
    p.w_qkv = (const float*)d_in[14]; p.w_o = (const float*)d_in[15]; p.sink = (const float*)d_in[16];
    p.out = (float*)d_out; p.ws = (unsigned char*)d_ws;
    void* args[] = {&p};
    hipError_t e = hipLaunchCooperativeKernel((const void*)mega_fwd, dim3(grid_blocks), dim3(NTHREADS), args, LDS_BYTES, stream);
    if (e != hipSuccess) fprintf(stderr, "cooperative launch failed: %s (grid %d)\n", hipGetErrorString(e), grid_blocks);
}
```
